# Optimizing an MI355X kernel written in HIP

```python
import jax, jax.numpy as jnp
from jax import lax
import numpy as np

D_MODEL = 1024
BATCH = 8
SEQ = 2048
DEPTH = 4

CHUNK = 64
Q_BLOCK = 128
N_MIXERS = 3
SB_HEADS = 16
SB_HEAD_DIM = D_MODEL // SB_HEADS
CONV_WIDTH = 3
ML_HEADS = 8
ML_QK_DIM = D_MODEL // (2 * ML_HEADS)
ML_V_DIM = D_MODEL // ML_HEADS
ML_QK_WIDTH = ML_HEADS * ML_QK_DIM
ML_IN_WIDTH = 2 * ML_QK_WIDTH + 2 * D_MODEL + 2 * ML_HEADS
D_FF = ((8 * D_MODEL + 3 * 256 - 1) // (3 * 256)) * 256
N_SB = (DEPTH + 2) // N_MIXERS
N_GC = (DEPTH + 1) // N_MIXERS
N_ML = DEPTH // N_MIXERS
RMS_EPS = 1e-6

kernel_name = "hybrid_stickbreak_conv_mlstm_encoder"


def rmsnorm(x, g):
    xf = x.astype(jnp.float32)
    y = xf * lax.rsqrt(jnp.mean(xf * xf, axis=-1, keepdims=True) + RMS_EPS)
    return (y * g.astype(jnp.float32)).astype(x.dtype)


def stick_breaking_mixer(h, w_qkv, w_o):
    bsz, seq, _ = h.shape
    q, k, v = jnp.split(h @ w_qkv, 3, axis=-1)

    def heads(t):
        return t.reshape(bsz, seq, SB_HEADS, SB_HEAD_DIM).transpose(0, 2, 1, 3)

    q, k, v = heads(q), heads(k), heads(v)
    scale = SB_HEAD_DIM ** -0.5
    outs = []
    for blk in range(seq // Q_BLOCK):
        t0, t1 = blk * Q_BLOCK, (blk + 1) * Q_BLOCK
        z = jnp.einsum('bhqd,bhkd->bhqk', q[:, :, t0:t1], k[:, :, :t1]).astype(jnp.float32) * scale
        before = jnp.arange(t1)[None, :] < jnp.arange(t0, t1)[:, None]
        log_stay = jnp.where(before, jax.nn.log_sigmoid(-z), 0.0)
        log_pass = lax.cumsum(log_stay, axis=3, reverse=True) - log_stay
        a = jnp.where(before, jnp.exp(jax.nn.log_sigmoid(z) + log_pass), 0.0)
        outs.append(jnp.einsum('bhqk,bhkd->bhqd', a.astype(v.dtype), v[:, :, :t1]))
    o = jnp.concatenate(outs, axis=2).transpose(0, 2, 1, 3).reshape(bsz, seq, D_MODEL)
    return o @ w_o


def gated_conv_mixer(h, w_in, conv_w, conv_b, w_out):
    b_gate, c_gate, u = jnp.split(h @ w_in, 3, axis=-1)
    cu = c_gate * u
    y = lax.conv_general_dilated(
        cu, conv_w[:, None, :].astype(cu.dtype), window_strides=(1,),
        padding=[(CONV_WIDTH - 1, 0)], dimension_numbers=('NWC', 'WIO', 'NWC'),
        feature_group_count=D_MODEL) + conv_b
    return (b_gate * y) @ w_out


def _mlstm_chunk_step(carry, inp):
    c_state, n_state, m_state = carry
    qc, kc, vc, igc, lfc = inp
    L = qc.shape[2]
    b = jnp.cumsum(lfc, axis=-1)
    causal = jnp.tril(jnp.ones((L, L), dtype=bool))
    log_d = jnp.where(causal, b[..., :, None] - b[..., None, :] + igc[..., None, :], -jnp.inf)
    m_inter = b + m_state[..., None]
    m_t = jnp.maximum(m_inter, jnp.max(log_d, axis=-1))
    d_mat = jnp.exp(log_d - m_t[..., None])
    inter = jnp.exp(m_inter - m_t)
    s = jnp.einsum('bhtd,bhsd->bhts', qc, kc) * d_mat
    num = jnp.einsum('bhts,bhsv->bhtv', s, vc) + inter[..., None] * jnp.einsum('bhvd,bhtd->bhtv', c_state, qc)
    den = jnp.sum(s, axis=-1) + inter * jnp.einsum('bhd,bhtd->bht', n_state, qc)
    h_out = num / jnp.maximum(jnp.abs(den), jnp.exp(-m_t))[..., None]
    b_last = b[..., -1]
    log_w = b_last[..., None] - b + igc
    m_new = jnp.maximum(b_last + m_state, jnp.max(log_w, axis=-1))
    w = jnp.exp(log_w - m_new[..., None])
    decay = jnp.exp(b_last + m_state - m_new)
    c_new = decay[..., None, None] * c_state + jnp.einsum('bhs,bhsv,bhsd->bhvd', w, vc, kc)
    n_new = decay[..., None] * n_state + jnp.einsum('bhs,bhsd->bhd', w, kc)
    return (c_new, n_new, m_new), h_out


def mlstm_mixer(h, w_in, b_i, b_f, w_out):
    bsz, seq, _ = h.shape
    cuts = [ML_QK_WIDTH, 2 * ML_QK_WIDTH, 2 * ML_QK_WIDTH + D_MODEL,
            2 * ML_QK_WIDTH + 2 * D_MODEL, 2 * ML_QK_WIDTH + 2 * D_MODEL + ML_HEADS]
    q, k, v, o_pre, i_pre, f_pre = jnp.split(h @ w_in, cuts, axis=-1)

    def heads(t, dh):
        return t.reshape(bsz, seq, ML_HEADS, dh).transpose(0, 2, 1, 3).astype(jnp.float32)

    q = heads(q, ML_QK_DIM)
    k = heads(k, ML_QK_DIM) * (ML_QK_DIM ** -0.5)
    v = heads(v, ML_V_DIM)
    ig = (i_pre + b_i).astype(jnp.float32).transpose(0, 2, 1)
    lf = jax.nn.log_sigmoid((f_pre + b_f).astype(jnp.float32)).transpose(0, 2, 1)
    n_chunks = seq // CHUNK

    def chunks(t):
        return jnp.moveaxis(t.reshape(bsz, ML_HEADS, n_chunks, CHUNK, *t.shape[3:]), 2, 0)

    init = (jnp.zeros((bsz, ML_HEADS, ML_V_DIM, ML_QK_DIM), jnp.float32),
            jnp.zeros((bsz, ML_HEADS, ML_QK_DIM), jnp.float32),
            jnp.zeros((bsz, ML_HEADS), jnp.float32))
    _, hs = lax.scan(_mlstm_chunk_step, init, (chunks(q), chunks(k), chunks(v), chunks(ig), chunks(lf)))
    hs = jnp.moveaxis(hs, 0, 2).reshape(bsz, ML_HEADS, seq, ML_V_DIM)
    hs = hs.transpose(0, 2, 1, 3).reshape(bsz, seq, D_MODEL).astype(h.dtype)
    return (jax.nn.sigmoid(o_pre) * hs) @ w_out


def swiglu_ffn(h, w_gu, w_down):
    g, u = jnp.split(h @ w_gu, 2, axis=-1)
    return (jax.nn.silu(g) * u) @ w_down


def setup_inputs(seed: int = 0) -> dict:
    key = jax.random.key(seed)
    ks = jax.random.split(key, 20)
    f32 = jnp.float32

    def dense(k, shape):
        return jax.random.normal(k, shape, f32) * (shape[-2] ** -0.5)

    def gain(k):
        return 1.0 + 0.05 * jax.random.normal(k, (DEPTH, D_MODEL), f32)

    return {
        "x": jax.random.normal(ks[0], (BATCH, SEQ, D_MODEL), f32),
        "ln_mix_pre": gain(ks[1]),
        "ln_mix_post": gain(ks[2]),
        "ln_ffn_pre": gain(ks[3]),
        "ln_ffn_post": gain(ks[4]),
        "sb_w_qkv": dense(ks[5], (N_SB, D_MODEL, 3 * D_MODEL)),
        "sb_w_o": dense(ks[6], (N_SB, D_MODEL, D_MODEL)),
        "gc_w_in": dense(ks[7], (N_GC, D_MODEL, 3 * D_MODEL)),
        "gc_conv_w": jax.random.normal(ks[8], (N_GC, CONV_WIDTH, D_MODEL), f32) * (CONV_WIDTH ** -0.5),
        "gc_conv_b": 0.02 * jax.random.normal(ks[9], (N_GC, D_MODEL), f32),
        "gc_w_out": dense(ks[10], (N_GC, D_MODEL, D_MODEL)),
        "ml_w_in": dense(ks[11], (N_ML, D_MODEL, ML_IN_WIDTH)),
        "ml_b_i": 0.1 * jax.random.normal(ks[12], (N_ML, ML_HEADS), f32),
        "ml_b_f": 3.0 + 0.5 * jax.random.normal(ks[13], (N_ML, ML_HEADS), f32),
        "ml_w_out": dense(ks[14], (N_ML, D_MODEL, D_MODEL)),
        "ffn_w_gu": dense(ks[15], (DEPTH, D_MODEL, 2 * D_FF)),
        "ffn_w_down": dense(ks[16], (DEPTH, D_FF, D_MODEL)),
    }


def reference(x, ln_mix_pre, ln_mix_post, ln_ffn_pre, ln_ffn_post,
              sb_w_qkv, sb_w_o, gc_w_in, gc_conv_w, gc_conv_b, gc_w_out,
              ml_w_in, ml_b_i, ml_b_f, ml_w_out, ffn_w_gu, ffn_w_down):
    for i in range(DEPTH):
        kind, j = i % N_MIXERS, i // N_MIXERS
        hn = rmsnorm(x, ln_mix_pre[i])
        if kind == 0:
            mixed = stick_breaking_mixer(hn, sb_w_qkv[j], sb_w_o[j])
        elif kind == 1:
            mixed = gated_conv_mixer(hn, gc_w_in[j], gc_conv_w[j], gc_conv_b[j], gc_w_out[j])
        else:
            mixed = mlstm_mixer(hn, ml_w_in[j], ml_b_i[j], ml_b_f[j], ml_w_out[j])
        x = x + rmsnorm(mixed, ln_mix_post[i])
        hn = rmsnorm(x, ln_ffn_pre[i])
        x = x + rmsnorm(swiglu_ffn(hn, ffn_w_gu[i], ffn_w_down[i]), ln_ffn_post[i])
    return x
```

```cpp
#include <hip/hip_runtime.h>
#include <cstdint>
#include <cstdio>

namespace nv {
constexpr int D = 1024, BATCH = 8, SEQ = 2048, M = BATCH * SEQ, DFF = 2816;
constexpr int SBH = 16, SBD = 64, MLH = 8, MLQK = 64, MLV = 128, MLIN = 3088;
constexpr float EPS = 1e-6f;

__device__ __forceinline__ float wave_sum(float v) {
#pragma unroll
    for (int o = 1; o < 64; o <<= 1) v += __shfl_xor(v, o);
    return v;
}
__global__ void __launch_bounds__(256) k_rmsnorm(const float* __restrict__ x, const float* __restrict__ g, float* __restrict__ y, int rows) {
    const int lane = threadIdx.x & 63, row = blockIdx.x * 4 + (threadIdx.x >> 6);
    if (row >= rows) return;
    const float* xr = x + (size_t)row * D; float v[16]; float s = 0.f;
#pragma unroll
    for (int j = 0; j < 16; ++j) { v[j] = xr[lane + 64 * j]; s += v[j] * v[j]; }
    const float rs = rsqrtf(wave_sum(s) * (1.f / D) + EPS);
#pragma unroll
    for (int j = 0; j < 16; ++j) y[(size_t)row * D + lane + 64 * j] = v[j] * rs * g[lane + 64 * j];
}
__global__ void __launch_bounds__(256) k_res_rmsnorm(float* __restrict__ x, const float* __restrict__ yv, const float* __restrict__ g, int rows) {
    const int lane = threadIdx.x & 63, row = blockIdx.x * 4 + (threadIdx.x >> 6);
    if (row >= rows) return;
    const float* yr = yv + (size_t)row * D; float v[16]; float s = 0.f;
#pragma unroll
    for (int j = 0; j < 16; ++j) { v[j] = yr[lane + 64 * j]; s += v[j] * v[j]; }
    const float rs = rsqrtf(wave_sum(s) * (1.f / D) + EPS);
#pragma unroll
    for (int j = 0; j < 16; ++j) x[(size_t)row * D + lane + 64 * j] += v[j] * rs * g[lane + 64 * j];
}
__global__ void __launch_bounds__(256) k_gemm(const float* __restrict__ A, int lda, const float* __restrict__ W, int ldw, float* __restrict__ C, int ldc, int Mrows, int N, int K) {
    __shared__ float As[16][65]; __shared__ float Bs[16][65];
    const int tid = threadIdx.x, tx = tid & 15, ty = tid >> 4, m0 = blockIdx.y * 64, n0 = blockIdx.x * 64;
    float acc[4][4] = {};
    for (int k0 = 0; k0 < K; k0 += 16) {
#pragma unroll
        for (int i = 0; i < 4; ++i) { const int e = tid + 256 * i, r = e >> 4, c = e & 15; As[c][r] = A[(size_t)(m0 + r) * lda + k0 + c]; }
#pragma unroll
        for (int i = 0; i < 4; ++i) { const int e = tid + 256 * i, r = e >> 6, c = e & 63; Bs[r][c] = (n0 + c < N) ? W[(size_t)(k0 + r) * ldw + n0 + c] : 0.f; }
        __syncthreads();
#pragma unroll
        for (int kk = 0; kk < 16; ++kk) { float a[4], b[4];
#pragma unroll
            for (int i = 0; i < 4; ++i) { a[i] = As[kk][ty * 4 + i]; b[i] = Bs[kk][tx * 4 + i]; }
#pragma unroll
            for (int i = 0; i < 4; ++i)
#pragma unroll
                for (int j = 0; j < 4; ++j) acc[i][j] += a[i] * b[j]; }
        __syncthreads();
    }
#pragma unroll
    for (int i = 0; i < 4; ++i)
#pragma unroll
        for (int j = 0; j < 4; ++j) { const int n = n0 + tx * 4 + j; if (n < N) C[(size_t)(m0 + ty * 4 + i) * ldc + n] = acc[i][j]; }
}
__global__ void __launch_bounds__(64) k_sb_attn(const float* __restrict__ qkv, float* __restrict__ o) {
    const int t = blockIdx.x * 64 + threadIdx.x, h = blockIdx.y, b = blockIdx.z;
    const float* base = qkv + (size_t)b * SEQ * 3072 + h * 64;
    float q[64], acc[64];
#pragma unroll
    for (int d = 0; d < 64; ++d) { q[d] = base[(size_t)t * 3072 + d] * 0.125f; acc[d] = 0.f; }
    float pass = 0.f;
    const int smax = blockIdx.x * 64 + 63;
    for (int s = smax - 1; s >= 0; --s) {
        const float* kr = base + (size_t)s * 3072 + 1024; const float* vr = base + (size_t)s * 3072 + 2048;
        float z = 0.f;
#pragma unroll
        for (int d = 0; d < 64; ++d) z += q[d] * kr[d];
        if (s < t) {
            const float sp = fmaxf(z, 0.f) + log1pf(expf(-fabsf(z)));
            const float a = expf(z - sp + pass);
            pass -= sp;
#pragma unroll
            for (int d = 0; d < 64; ++d) acc[d] += a * vr[d];
        }
    }
#pragma unroll
    for (int d = 0; d < 64; ++d) o[(size_t)(b * SEQ + t) * D + h * 64 + d] = acc[d];
}
__global__ void __launch_bounds__(256) k_gconv(const float* __restrict__ p, const float* __restrict__ cw, const float* __restrict__ cb, float* __restrict__ y) {
    const size_t idx = (size_t)blockIdx.x * 256 + threadIdx.x; const int c = (int)(idx % D); const int row = (int)(idx / D), t = row % SEQ;
    const float* pr = p + (size_t)row * 3072;
    float s = cb[c] + cw[2 * D + c] * pr[1024 + c] * pr[2048 + c];
    if (t >= 1) s += cw[1 * D + c] * pr[1024 + c - 3072] * pr[2048 + c - 3072];
    if (t >= 2) s += cw[0 * D + c] * pr[1024 + c - 2 * 3072] * pr[2048 + c - 2 * 3072];
    y[idx] = pr[c] * s;
}
__global__ void __launch_bounds__(256) k_mlstm(const float* __restrict__ p, const float* __restrict__ bi, const float* __restrict__ bf, float* __restrict__ y) {
    const int vg = blockIdx.x, h = blockIdx.y, b = blockIdx.z, tid = threadIdx.x, vi = tid >> 4, dj = tid & 15, v = vg * 16 + vi;
    float C[4] = {0.f, 0.f, 0.f, 0.f}, n[4] = {0.f, 0.f, 0.f, 0.f}; float m = 0.f;
    const float bih = bi[h], bfh = bf[h];
    for (int t = 0; t < SEQ; ++t) {
        const float* pr = p + (size_t)(b * SEQ + t) * MLIN;
        const float ig = pr[3072 + h] + bih; const float fp = pr[3080 + h] + bfh;
        const float lf = fminf(fp, 0.f) - log1pf(expf(-fabsf(fp)));
        const float mn = fmaxf(lf + m, ig), fd = expf(lf + m - mn), iw = expf(ig - mn);
        const float vv = pr[1024 + h * 128 + v]; float cq = 0.f, nq = 0.f;
#pragma unroll
        for (int j = 0; j < 4; ++j) { const float kk = pr[512 + h * 64 + 4 * dj + j] * 0.125f, qq = pr[h * 64 + 4 * dj + j];
            C[j] = fd * C[j] + iw * vv * kk; n[j] = fd * n[j] + iw * kk; cq += C[j] * qq; nq += n[j] * qq; }
#pragma unroll
        for (int o = 1; o < 16; o <<= 1) { cq += __shfl_xor(cq, o); nq += __shfl_xor(nq, o); }
        m = mn;
        if (dj == 0) { const float hv = cq / fmaxf(fabsf(nq), expf(-m)); const float og = pr[2048 + h * 128 + v];
            y[(size_t)(b * SEQ + t) * D + h * 128 + v] = hv / (1.f + expf(-og)); }
    }
}
__global__ void __launch_bounds__(256) k_swiglu(const float* __restrict__ gu, float* __restrict__ hid) {
    const size_t idx = (size_t)blockIdx.x * 256 + threadIdx.x; const int c = (int)(idx % DFF); const size_t row = idx / DFF;
    const float g = gu[row * 5632 + c], u = gu[row * 5632 + DFF + c];
    hid[idx] = g / (1.f + expf(-g)) * u;
}
}

extern "C" void kernel_launch(void* const* d_in, const int* in_sizes, int n_in, void* d_out, int out_size, void* d_ws, size_t ws_size, hipStream_t stream) {
    using namespace nv;
    const float* x0 = (const float*)d_in[0];
    const float *g_mpre = (const float*)d_in[1], *g_mpost = (const float*)d_in[2], *g_fpre = (const float*)d_in[3], *g_fpost = (const float*)d_in[4];
    const float *sb_wqkv = (const float*)d_in[5], *sb_wo = (const float*)d_in[6], *gc_win = (const float*)d_in[7], *gc_cw = (const float*)d_in[8], *gc_cb = (const float*)d_in[9], *gc_wout = (const float*)d_in[10];
    const float *ml_win = (const float*)d_in[11], *ml_bi = (const float*)d_in[12], *ml_bf = (const float*)d_in[13], *ml_wout = (const float*)d_in[14], *w_gu = (const float*)d_in[15], *w_dn = (const float*)d_in[16];
    float* x = (float*)d_out;
    float* ws = (float*)d_ws;
    float* hn = ws;
    float* mixed = ws + (size_t)M * D;
    float* proj = ws + (size_t)2 * M * D;
    hipMemcpyAsync(x, x0, (size_t)M * D * 4, hipMemcpyDeviceToDevice, stream);
    for (int i = 0; i < 4; ++i) {
        const int kind = i % 3, j = i / 3;
        k_rmsnorm<<<M / 4, 256, 0, stream>>>(x, g_mpre + i * D, hn, M);
        if (kind == 0) {
            k_gemm<<<dim3(3072 / 64, M / 64), 256, 0, stream>>>(hn, D, sb_wqkv + (size_t)j * D * 3072, 3072, proj, 3072, M, 3072, D);
            k_sb_attn<<<dim3(SEQ / 64, SBH, BATCH), 64, 0, stream>>>(proj, mixed);
            k_gemm<<<dim3(D / 64, M / 64), 256, 0, stream>>>(mixed, D, sb_wo + (size_t)j * D * D, D, hn, D, M, D, D);
        } else if (kind == 1) {
            k_gemm<<<dim3(3072 / 64, M / 64), 256, 0, stream>>>(hn, D, gc_win + (size_t)j * D * 3072, 3072, proj, 3072, M, 3072, D);
            k_gconv<<<M * D / 256, 256, 0, stream>>>(proj, gc_cw + (size_t)j * 3 * D, gc_cb + (size_t)j * D, mixed);
            k_gemm<<<dim3(D / 64, M / 64), 256, 0, stream>>>(mixed, D, gc_wout + (size_t)j * D * D, D, hn, D, M, D, D);
        } else {
            k_gemm<<<dim3((MLIN + 63) / 64, M / 64), 256, 0, stream>>>(hn, D, ml_win + (size_t)j * D * MLIN, MLIN, proj, MLIN, M, MLIN, D);
            k_mlstm<<<dim3(8, MLH, BATCH), 256, 0, stream>>>(proj, ml_bi + j * MLH, ml_bf + j * MLH, mixed);
            k_gemm<<<dim3(D / 64, M / 64), 256, 0, stream>>>(mixed, D, ml_wout + (size_t)j * D * D, D, hn, D, M, D, D);
        }
        k_res_rmsnorm<<<M / 4, 256, 0, stream>>>(x, hn, g_mpost + i * D, M);
        k_rmsnorm<<<M / 4, 256, 0, stream>>>(x, g_fpre + i * D, hn, M);
        for (int c = 0; c < 4; ++c) {
            const int R = M / 4; float* gu = proj; float* hid = proj + (size_t)R * 5632;
            k_gemm<<<dim3(5632 / 64, R / 64), 256, 0, stream>>>(hn + (size_t)c * R * D, D, w_gu + (size_t)i * D * 5632, 5632, gu, 5632, R, 5632, D);
            k_swiglu<<<R * DFF / 256, 256, 0, stream>>>(gu, hid);
            k_gemm<<<dim3(D / 64, R / 64), 256, 0, stream>>>(hid, DFF, w_dn + (size_t)i * DFF * D, D, mixed + (size_t)c * R * D, D, R, D, DFF);
        }
        k_res_rmsnorm<<<M / 4, 256, 0, stream>>>(x, mixed, g_fpost + i * D, M);
    }
}
```
